# Optimizing an MI355X kernel written in HIP

```python
import math
import jax, jax.numpy as jnp
from jax import lax
import numpy as np

D_MODEL = 2048
BATCH = 1
SEQ = 8192
DEPTH = 4

C_A = 512
H_B = 16
HEAD_DIM = 64
C_B = H_B * HEAD_DIM
C_C = 512
POOL_WINDOWS = (2, 4, 8, 16)
N_POOL_GROUPS = len(POOL_WINDOWS)
C_G = C_C // N_POOL_GROUPS
MIX_WIDTH = C_A + C_B + C_C
IN_WIDTH = 2 * C_A + 3 * C_B + C_C

CONV_WIDTH = 31
CONV_HALF = CONV_WIDTH // 2

DILATED_PATTERNS = ((128, 1), (512, 4), (2048, 16))
ATTN_BLOCK = 64
ROT_DIM = HEAD_DIM // 4
ROPE_THETA = 500000.0

FFN_HIDDEN = int(math.ceil((8 * D_MODEL / 3) / 256) * 256)
EPS = 1e-6
NEG = -1e30

kernel_name = "hybrid_conv_dilatedattn_pool_encoder"


def rms_normalize(t):
    tf = t.astype(jnp.float32)
    return tf * lax.rsqrt(jnp.mean(tf * tf, axis=-1, keepdims=True) + EPS)


def rmsnorm(t, g):
    return (rms_normalize(t) * g.astype(jnp.float32)).astype(t.dtype)


def rope_tables(S):
    pos = jnp.arange(S, dtype=jnp.float32)
    inv = ROPE_THETA ** (-jnp.arange(0, ROT_DIM, 2, dtype=jnp.float32) / ROT_DIM)
    ang = pos[:, None] * inv[None, :]
    return jnp.cos(ang), jnp.sin(ang)


def apply_partial_rope(t, cos, sin):
    half = ROT_DIM // 2
    t1 = t[..., :half]
    t2 = t[..., half:ROT_DIM]
    c = cos[None, :, None, :]
    s = sin[None, :, None, :]
    return jnp.concatenate([t1 * c - t2 * s, t2 * c + t1 * s, t[..., ROT_DIM:]], axis=-1)


def conformer_conv(u, w, b, ln_g, ln_b):
    a, gate = jnp.split(u, 2, axis=-1)
    h = a * jax.nn.sigmoid(gate)
    h = lax.conv_general_dilated(
        h, w[:, None, :], window_strides=(1,),
        padding=[(CONV_HALF, CONV_HALF)],
        dimension_numbers=('NWC', 'WIO', 'NWC'),
        feature_group_count=C_A) + b
    hf = h.astype(jnp.float32)
    mu = jnp.mean(hf, axis=-1, keepdims=True)
    var = jnp.mean(jnp.square(hf - mu), axis=-1, keepdims=True)
    hf = (hf - mu) * lax.rsqrt(var + EPS) * ln_g.astype(jnp.float32) + ln_b.astype(jnp.float32)
    return jax.nn.silu(hf).astype(u.dtype)


def banded_dilated_stats(q, k, v, dilation, half):
    B, S, H, E = q.shape
    L = S // dilation
    nb = -(-L // ATTN_BLOCK)
    Lp = nb * ATTN_BLOCK
    qd = q.reshape(B, L, dilation, H, E)
    kd = k.reshape(B, L, dilation, H, E)
    vd = v.reshape(B, L, dilation, H, E)
    pad_q = ((0, 0), (0, Lp - L), (0, 0), (0, 0), (0, 0))
    pad_kv = ((0, 0), (ATTN_BLOCK, Lp - L + ATTN_BLOCK), (0, 0), (0, 0), (0, 0))
    qb = jnp.pad(qd, pad_q).reshape(B, nb, ATTN_BLOCK, dilation, H, E)
    kb = jnp.pad(kd, pad_kv).reshape(B, nb + 2, ATTN_BLOCK, dilation, H, E)
    vb = jnp.pad(vd, pad_kv).reshape(B, nb + 2, ATTN_BLOCK, dilation, H, E)
    kwin = jnp.concatenate([kb[:, :-2], kb[:, 1:-1], kb[:, 2:]], axis=2)
    vwin = jnp.concatenate([vb[:, :-2], vb[:, 1:-1], vb[:, 2:]], axis=2)
    blk = jnp.arange(nb)[:, None]
    jq = blk * ATTN_BLOCK + jnp.arange(ATTN_BLOCK)[None, :]
    jk = (blk - 1) * ATTN_BLOCK + jnp.arange(3 * ATTN_BLOCK)[None, :]
    mask = ((jnp.abs(jk[:, None, :] - jq[:, :, None]) <= half)
            & (jk[:, None, :] >= 0) & (jk[:, None, :] < L))
    scores = jnp.einsum('bnqrhe,bnkrhe->bnrhqk', qb, kwin)
    maskb = mask[None, :, None, None, :, :]
    scores = jnp.where(maskb, scores, NEG)
    m = jnp.max(scores, axis=-1)
    p = jnp.where(maskb, jnp.exp(scores - m[..., None]), 0.0)
    s = jnp.sum(p, axis=-1)
    o = jnp.einsum('bnrhqk,bnkrhe->bnqrhe', p, vwin)
    m = jnp.transpose(m, (0, 1, 4, 2, 3)).reshape(B, Lp, dilation, H)[:, :L].reshape(B, S, H)
    s = jnp.transpose(s, (0, 1, 4, 2, 3)).reshape(B, Lp, dilation, H)[:, :L].reshape(B, S, H)
    o = o.reshape(B, Lp, dilation, H, E)[:, :L].reshape(B, S, H, E)
    return m, s, o


def dilated_attention(qkv, cos, sin):
    B, S, _ = qkv.shape
    q, k, v = jnp.split(qkv.astype(jnp.float32), 3, axis=-1)
    q = apply_partial_rope(q.reshape(B, S, H_B, HEAD_DIM), cos, sin) * (HEAD_DIM ** -0.5)
    k = apply_partial_rope(k.reshape(B, S, H_B, HEAD_DIM), cos, sin)
    v = v.reshape(B, S, H_B, HEAD_DIM)
    ms, ss, os_ = [], [], []
    for window, dilation in DILATED_PATTERNS:
        m, s, o = banded_dilated_stats(q, k, v, dilation, window // (2 * dilation))
        ms.append(m); ss.append(s); os_.append(o)
    m_all = jnp.stack(ms)
    s_all = jnp.stack(ss)
    o_all = jnp.stack(os_)
    wgt = jnp.exp(m_all - jnp.max(m_all, axis=0, keepdims=True))
    num = jnp.sum(wgt[..., None] * o_all, axis=0)
    den = jnp.sum(wgt * s_all, axis=0)
    out = num / den[..., None]
    return out.reshape(B, S, C_B).astype(qkv.dtype)


def pool_mixer(u, w, scale):
    B, S, _ = u.shape
    uf = u.astype(jnp.float32)
    cs = jnp.concatenate([jnp.zeros((B, 1, C_C), jnp.float32), jnp.cumsum(uf, axis=1)], axis=1)
    pos = jnp.arange(S)
    outs = []
    for gi, win in enumerate(POOL_WINDOWS):
        seg = cs[..., gi * C_G:(gi + 1) * C_G]
        lo = jnp.clip(pos - win // 2, 0, S)
        hi = jnp.clip(pos + win - win // 2, 0, S)
        mean = (seg[:, hi] - seg[:, lo]) / (hi - lo).astype(jnp.float32)[None, :, None]
        outs.append(mean - uf[..., gi * C_G:(gi + 1) * C_G])
    pooled = jnp.stack(outs, axis=2)
    mixed = jnp.einsum('bsgc,gcd->bsgd', pooled, w.astype(jnp.float32))
    return (mixed.reshape(B, S, C_C) * scale.astype(jnp.float32)).astype(u.dtype)


def setup_inputs(seed: int = 0) -> dict:
    key = jax.random.key(seed)
    ks = jax.random.split(key, 20)
    f32 = jnp.float32

    def nrm(k, shape, scale):
        return jax.random.normal(k, shape, f32) * scale

    def gain(k, shape):
        return 1.0 + 0.05 * jax.random.normal(k, shape, f32)

    return {
        "x": jax.random.normal(ks[0], (BATCH, SEQ, D_MODEL), f32),
        "w_in": nrm(ks[1], (DEPTH, D_MODEL, IN_WIDTH), D_MODEL ** -0.5),
        "conv_w": nrm(ks[2], (DEPTH, CONV_WIDTH, C_A), CONV_WIDTH ** -0.5),
        "conv_b": nrm(ks[3], (DEPTH, C_A), 0.02),
        "conv_ln_g": gain(ks[4], (DEPTH, C_A)),
        "conv_ln_b": nrm(ks[5], (DEPTH, C_A), 0.02),
        "pool_w": nrm(ks[6], (DEPTH, N_POOL_GROUPS, C_G, C_G), C_G ** -0.5),
        "pool_scale": gain(ks[7], (DEPTH, C_C)),
        "g_mix": gain(ks[8], (DEPTH, MIX_WIDTH)),
        "w_out": nrm(ks[9], (DEPTH, MIX_WIDTH, D_MODEL), MIX_WIDTH ** -0.5),
        "g_pre_mix": gain(ks[10], (DEPTH, D_MODEL)),
        "g_post_mix": gain(ks[11], (DEPTH, D_MODEL)),
        "g_pre_ffn": gain(ks[12], (DEPTH, D_MODEL)),
        "g_post_ffn": gain(ks[13], (DEPTH, D_MODEL)),
        "w_gate": nrm(ks[14], (DEPTH, D_MODEL, FFN_HIDDEN), D_MODEL ** -0.5),
        "w_up": nrm(ks[15], (DEPTH, D_MODEL, FFN_HIDDEN), D_MODEL ** -0.5),
        "w_down": nrm(ks[16], (DEPTH, FFN_HIDDEN, D_MODEL), FFN_HIDDEN ** -0.5),
    }


def reference(x, w_in, conv_w, conv_b, conv_ln_g, conv_ln_b, pool_w, pool_scale, g_mix,
              w_out, g_pre_mix, g_post_mix, g_pre_ffn, g_post_ffn, w_gate, w_up, w_down):
    S = x.shape[1]
    cos, sin = rope_tables(S)
    a_end = 2 * C_A
    b_end = a_end + 3 * C_B
    for l in range(DEPTH):
        h = rmsnorm(x, g_pre_mix[l])
        proj = h @ w_in[l]
        y_a = conformer_conv(proj[..., :a_end], conv_w[l], conv_b[l], conv_ln_g[l], conv_ln_b[l])
        y_b = dilated_attention(proj[..., a_end:b_end], cos, sin)
        y_c = pool_mixer(proj[..., b_end:], pool_w[l], pool_scale[l])
        y = jnp.concatenate([rms_normalize(y_a), rms_normalize(y_b), rms_normalize(y_c)], axis=-1)
        y = (y * g_mix[l].astype(jnp.float32)).astype(x.dtype)
        x = x + rmsnorm(y @ w_out[l], g_post_mix[l])
        h = rmsnorm(x, g_pre_ffn[l])
        f = (jax.nn.silu(h @ w_gate[l]) * (h @ w_up[l])) @ w_down[l]
        x = x + rmsnorm(f, g_post_ffn[l])
    return x
```

```cpp
#include <hip/hip_runtime.h>
#include <cstdio>
#include <cstdint>
namespace pg8 {
#define PG8_LAS __attribute__((address_space(3)))
typedef unsigned short bf16_t;
typedef short bf16x8 __attribute__((ext_vector_type(8)));
typedef float f32x4 __attribute__((ext_vector_type(4)));
typedef unsigned u32x4 __attribute__((ext_vector_type(4)));
constexpr int BM = 256, BK = 64, HALF = 128, HTB = HALF * BK * 2  , STAGE_BYTES = 8 * HTB, NXCD = 8, WGM = 8;

__host__ __device__ __forceinline__ int lds_byte(int r, int c) { const int st = (r >> 4) * 2 + (c >> 5), rr = r & 15, cc = c & 31, ob = rr * 64 + cc * 2; return st * 1024 + (ob ^ (((ob >> 9) & 1) << 5)); }
__host__ __device__ __forceinline__ void stage_rc(int b, int& R, int& C) { const int st = b / 1024, sb = b % 1024, swz = sb ^ (((sb >> 9) & 1) << 5); R = (st >> 1) * 16 + swz / 64; C = (st & 1) * 32 + (swz % 64) / 2; }
__host__ __device__ __forceinline__ int perm32(int rho) { const int n = rho >> 4, i = rho & 15; return 8 * (i >> 2) + 4 * n + (i & 3); }

struct Unit { int pm, pn; };
struct Gemm { const bf16_t* A; const bf16_t* Bt; int M, N, K; };

struct StaticOrder {
    int nM, nN, nwg, G, c;
    __host__ __device__ void init(int M, int N, int G_, int c_) { nM = M / BM; nN = N / BM; nwg = nM * nN; G = G_; c = c_; }
    __host__ __device__ bool next(int i, Unit& u) const {
        const long L = (long)i * G + c; if (L >= nwg) return false;
        int wgid = (int)L; { const int q = nwg / NXCD, r = nwg % NXCD, xcd = wgid % NXCD, off = wgid / NXCD; wgid = (xcd < r ? xcd * (q + 1) : r * (q + 1) + (xcd - r) * q) + off; }
        const int nig = WGM * nN, gid = wgid / nig, fm = gid * WGM, gsz = (nM - fm) < WGM ? (nM - fm) : WGM;
        u.pm = fm + ((wgid % nig) % gsz); u.pn = (wgid % nig) / gsz; return true;
    }
    __device__ __forceinline__ void a_ready(const Unit&) const {}
    __device__ __forceinline__ void done(const Unit&) const {}
};
typedef float f32x2c_t __attribute__((ext_vector_type(2))); typedef __bf16 bf16x2c_t __attribute__((ext_vector_type(2)));
__device__ __forceinline__ unsigned cvt_pk_bf16(float lo, float hi) { const f32x2c_t v = {lo, hi}; const bf16x2c_t b = __builtin_convertvector(v, bf16x2c_t); return __builtin_bit_cast(unsigned, b); }
typedef float f32x2 __attribute__((ext_vector_type(2)));
template <int M> __device__ __forceinline__ float shx(float v) { return __builtin_bit_cast(float, __builtin_amdgcn_ds_swizzle(__builtin_bit_cast(int, v), (M << 10) | 0x1f)); }
__device__ __forceinline__ float sum32(float v) { unsigned a = __builtin_bit_cast(unsigned, v), b = a; asm volatile("" : "+v"(b)); const auto rr = __builtin_amdgcn_permlane32_swap(a, b, false, false); unsigned r0 = rr[0], r1 = rr[1]; asm volatile("" : "+v"(r0), "+v"(r1)); return __builtin_bit_cast(float, r0) + __builtin_bit_cast(float, r1); }
__device__ __forceinline__ float max32(float v) { unsigned a = __builtin_bit_cast(unsigned, v), b = a; asm volatile("" : "+v"(b)); const auto rr = __builtin_amdgcn_permlane32_swap(a, b, false, false); unsigned r0 = rr[0], r1 = rr[1]; asm volatile("" : "+v"(r0), "+v"(r1)); return fmaxf(__builtin_bit_cast(float, r0), __builtin_bit_cast(float, r1)); }
__device__ __forceinline__ float sigm(float x) { return __builtin_amdgcn_rcpf(1.0f + __builtin_amdgcn_exp2f(-1.4426950408889634f * x)); }
__device__ __forceinline__ u32x4 pack8(const f32x4 v0, const f32x4 v1) { u32x4 w; w.x = cvt_pk_bf16(v0[0], v0[1]); w.y = cvt_pk_bf16(v0[2], v0[3]); w.z = cvt_pk_bf16(v1[0], v1[1]); w.w = cvt_pk_bf16(v1[2], v1[3]); return w; }
template <bool SWI> __device__ __forceinline__ void epi_gated(const f32x4 (&acc)[2][2][4][2], const Unit& u, int wr, int wc, int fr, int fq, bf16_t* O, int ldo) {
    const int row0 = u.pm * BM + wr * 64 + fr; const int col0 = u.pn * HALF + wc * 32 + 8 * fq;
#pragma unroll
    for (int ai = 0; ai < 2; ++ai)
#pragma unroll
        for (int m = 0; m < 4; ++m) { bf16_t* rowp = O + (size_t)(row0 + ai * HALF + m * 16) * ldo + col0;
            f32x4 r[2];
#pragma unroll
            for (int n = 0; n < 2; ++n) { const f32x4 a = acc[ai][0][m][n], g = acc[ai][1][m][n];
#pragma unroll
                for (int j = 0; j < 4; ++j) { const float s = sigm(g[j]); r[n][j] = SWI ? a[j] * (g[j] * s) : a[j] * s; } }
            *(u32x4*)rowp = pack8(r[0], r[1]); }
}
__device__ __forceinline__ void epi_plain(const f32x4 (&acc)[2][2][4][2], const Unit& u, int wr, int wc, int fr, int fq, bf16_t* O, int ldo, int colbase) {
    const int row0 = u.pm * BM + wr * 64 + fr; const int col0 = colbase + wc * 32 + 8 * fq;
#pragma unroll
    for (int ai = 0; ai < 2; ++ai)
#pragma unroll
        for (int m = 0; m < 4; ++m) { bf16_t* rowp = O + (size_t)(row0 + ai * HALF + m * 16) * ldo + col0;
#pragma unroll
            for (int bj = 0; bj < 2; ++bj) *(u32x4*)(rowp + bj * HALF) = pack8(acc[ai][bj][m][0], acc[ai][bj][m][1]); }
}
struct EpiPlain { static constexpr bool PERM = true, AFTER_DRAIN = false; bf16_t* O; int ldo;
    __device__ __forceinline__ void operator()(const f32x4 (&acc)[2][2][4][2], const Unit& u, int wr, int wc, int fr, int fq) const { epi_plain(acc, u, wr, wc, fr, fq, O, ldo, u.pn * BM); } };
struct EpiSwiglu { static constexpr bool PERM = true, AFTER_DRAIN = false; bf16_t* O; int ldo;
    __device__ __forceinline__ void operator()(const f32x4 (&acc)[2][2][4][2], const Unit& u, int wr, int wc, int fr, int fq) const { epi_gated<true>(acc, u, wr, wc, fr, fq, O, ldo); } };
struct EpiWin { static constexpr bool PERM = true, AFTER_DRAIN = false; bf16_t* glu; bf16_t* qkv; bf16_t* pool; const float* rope;
    __device__ __forceinline__ void operator()(const f32x4 (&acc)[2][2][4][2], const Unit& u, int wr, int wc, int fr, int fq) const {
        if (u.pn < 4) { epi_gated<false>(acc, u, wr, wc, fr, fq, glu, 512); return; }
        if (u.pn >= 16) { epi_plain(acc, u, wr, wc, fr, fq, pool, 512, (u.pn - 16) * BM); return; }
        const int t = u.pn - 4;
        if (t >= 8) { epi_plain(acc, u, wr, wc, fr, fq, qkv, 3072, t * BM); return; }
        const float sc = t < 4 ? 0.125f * 1.4426950408889634f : 1.0f;
        const int row0 = u.pm * BM + wr * 64 + fr; const int col0 = t * BM + wc * 32 + 8 * fq;
#ifdef ALT_ROPE
        const bool ropew = false;
#else
        const bool ropew = (wc & 1) == 0;
#endif
        const float sgn = fq == 0 ? -1.0f : 1.0f; const bool ropel = fq < 2;
#pragma unroll
        for (int ai = 0; ai < 2; ++ai)
#pragma unroll
            for (int m = 0; m < 4; ++m) { const int row = row0 + ai * HALF + m * 16; bf16_t* rowp = qkv + (size_t)row * 3072 + col0;
                f32x4 v[2][2];
#pragma unroll
                for (int bj = 0; bj < 2; ++bj)
#pragma unroll
                    for (int n = 0; n < 2; ++n) v[bj][n] = acc[ai][bj][m][n];
                if (ropew) { const f32x4* cs = (const f32x4*)(rope + (size_t)row * 16); const f32x4 c0 = cs[0], c1 = cs[1], s0 = cs[2], s1 = cs[3];
#pragma unroll
                    for (int bj = 0; bj < 2; ++bj)
#pragma unroll
                        for (int n = 0; n < 2; ++n) { const f32x4 c = n ? c1 : c0, s = n ? s1 : s0; f32x4 pv;
#pragma unroll
                            for (int j = 0; j < 4; ++j) pv[j] = shx<16>(v[bj][n][j]);
                            if (ropel) {
#pragma unroll
                                for (int j = 0; j < 4; ++j) v[bj][n][j] = v[bj][n][j] * c[j] + sgn * pv[j] * s[j]; } } }
#pragma unroll
                for (int bj = 0; bj < 2; ++bj) *(u32x4*)(rowp + bj * HALF) = pack8(v[bj][0] * sc, v[bj][1] * sc); }
    }
};

template <class Epi, class Sched, bool ALIGN_EPI = false, bool SP2 = false>
__device__ __forceinline__ void gemm_phase(PG8_LAS unsigned char* lds, const Gemm g, const Sched& S, const Epi& E, int tid_in) {
    int tid_ = tid_in; asm volatile("" : "+v"(tid_));
    const int tid = tid_, wid = __builtin_amdgcn_readfirstlane(tid >> 6), lane = tid & 63, wr = wid >> 2, wc = wid & 3, fr = lane & 15, fq = lane >> 4;
    const int K = g.K, nt = K / BK;
    unsigned voffA[2], voffB[2];
#pragma unroll
    for (int i = 0; i < 2; ++i) { int R, C; stage_rc(tid * 16 + i * 8192, R, C); const int Rb = Epi::PERM ? ((R & ~31) + perm32(R & 31)) : R;
        voffA[i] = (unsigned)(R * K + C) * 2u; voffB[i] = (unsigned)(Rb * K + C) * 2u; }
    const size_t kstep = (size_t)(BK * 2);
    const size_t hstep = (size_t)HALF * K * 2;
    const size_t tstep = 2 * hstep;
    const unsigned ldsw = (unsigned)wid * 1024u;
    const int aoff = lds_byte(wr * 64 + fr, fq * 8), boff = lds_byte(wc * 32 + fr, fq * 8);
#define PG8_SA(b, h) (((b) * 2 + (h)) * HTB)
#define PG8_SB(b, h) ((4 + (b) * 2 + (h)) * HTB)
#define PG8_STAGE(bufoff, gbase, voff) do { _Pragma("unroll") for (int _i = 0; _i < 2; ++_i) \
        __builtin_amdgcn_global_load_lds((const unsigned*)((const char*)(gbase) + (voff)[_i]), (PG8_LAS unsigned*)(lds + (bufoff) + ldsw + _i * 8192), 16, 0, 0); } while (0)
#define PG8_LDA(dst, b, h) do { _Pragma("unroll") for (int m = 0; m < 4; ++m) _Pragma("unroll") for (int k = 0; k < 2; ++k) dst[m][k] = *(const PG8_LAS bf16x8*)(lds + PG8_SA(b, h) + aoff + m * 2048 + k * 1024); } while (0)
#define PG8_LDB(dst, b, h) do { _Pragma("unroll") for (int n = 0; n < 2; ++n) _Pragma("unroll") for (int k = 0; k < 2; ++k) dst[n][k] = *(const PG8_LAS bf16x8*)(lds + PG8_SB(b, h) + boff + n * 2048 + k * 1024); } while (0)
#define PG8_MMA(ai, bj, At, Bt) do { __builtin_amdgcn_s_setprio(1); _Pragma("unroll") for (int m = 0; m < 4; ++m) _Pragma("unroll") for (int n = 0; n < 2; ++n) _Pragma("unroll") for (int k = 0; k < 2; ++k) \
        acc[ai][bj][m][n] = __builtin_amdgcn_mfma_f32_16x16x32_bf16(Bt[n][k], At[m][k], acc[ai][bj][m][n], 0, 0, 0); __builtin_amdgcn_s_setprio(0); } while (0)
#define PG8_WAIT_V(n) asm volatile("s_waitcnt vmcnt(" #n ")" ::: "memory")
#define PG8_WAIT_L(n) asm volatile("s_waitcnt lgkmcnt(" #n ")" ::: "memory")
#define PG8_BAR __builtin_amdgcn_s_barrier()
#define PG8_SCHED __builtin_amdgcn_sched_barrier(0)
    Unit cur, nxt; int ui = 0;
    if (!S.next(0, cur)) return;
    f32x4 acc[2][2][4][2];
#pragma unroll
    for (int a = 0; a < 2; ++a)
#pragma unroll
        for (int b = 0; b < 2; ++b)
#pragma unroll
            for (int m = 0; m < 4; ++m)
#pragma unroll
                for (int n = 0; n < 2; ++n) acc[a][b][m][n] = (f32x4){0.f, 0.f, 0.f, 0.f};
    bf16x8 At[4][2], B0[2][2], B1[2][2];
    const char* cA = (const char*)g.A + (size_t)cur.pm * tstep; const char* cB = (const char*)g.Bt + (size_t)cur.pn * tstep;
    S.a_ready(cur);
    if constexpr (SP2) {
        PG8_STAGE(PG8_SB(0, 0), cB, voffB); PG8_STAGE(PG8_SB(0, 1), cB + hstep, voffB); PG8_STAGE(PG8_SA(0, 0), cA, voffA); PG8_STAGE(PG8_SA(0, 1), cA + hstep, voffA);
        if (wr == 1) PG8_BAR;
        PG8_WAIT_V(2); PG8_BAR;
        PG8_STAGE(PG8_SB(1, 0), cB + kstep, voffB); PG8_STAGE(PG8_SA(1, 0), cA + kstep, voffA); PG8_STAGE(PG8_SB(1, 1), cB + hstep + kstep, voffB);
        PG8_WAIT_V(6); PG8_BAR;
    } else {
        PG8_STAGE(PG8_SB(0, 0), cB, voffB); PG8_STAGE(PG8_SA(0, 0), cA, voffA); PG8_STAGE(PG8_SB(0, 1), cB + hstep, voffB); PG8_STAGE(PG8_SA(0, 1), cA + hstep, voffA);
        if (wr == 1) PG8_BAR;
        PG8_WAIT_V(4); PG8_BAR;
        PG8_STAGE(PG8_SB(1, 0), cB + kstep, voffB); PG8_STAGE(PG8_SA(1, 0), cA + kstep, voffA); PG8_STAGE(PG8_SB(1, 1), cB + hstep + kstep, voffB);
        PG8_WAIT_V(6); PG8_BAR;
    }
    for (;;) {
        const bool has_next = S.next(ui + 1, nxt);
        const char* nA = has_next ? (const char*)g.A + (size_t)nxt.pm * tstep : cA; const char* nB = has_next ? (const char*)g.Bt + (size_t)nxt.pn * tstep : cB;
        for (int t = 0; t < nt; t += 2) {
            const bool last = (t == nt - 2);
            const char* a1 = cA + (size_t)(t + 1) * kstep;
            const char* a2 = last ? nA : cA + (size_t)(t + 2) * kstep; const char* b2 = last ? nB : cB + (size_t)(t + 2) * kstep;
            const char* a3 = a2 + kstep; const char* b3 = b2 + kstep;
            if (last && has_next) S.a_ready(nxt);
            if constexpr (SP2) {
            PG8_LDB(B0, 0, 0); PG8_LDB(B1, 0, 1); PG8_SCHED; PG8_LDA(At, 0, 0); PG8_STAGE(PG8_SA(1, 1), a1 + hstep, voffA);
            PG8_WAIT_V(8); PG8_WAIT_L(0); PG8_BAR; PG8_MMA(0, 0, At, B0); PG8_MMA(0, 1, At, B1); PG8_BAR; PG8_SCHED;
            PG8_LDA(At, 0, 1); PG8_STAGE(PG8_SB(0, 0), b2, voffB); PG8_STAGE(PG8_SB(0, 1), b2 + hstep, voffB); PG8_STAGE(PG8_SA(0, 0), a2, voffA);
            PG8_WAIT_V(8); PG8_WAIT_L(0); PG8_BAR; PG8_MMA(1, 0, At, B0); PG8_MMA(1, 1, At, B1); PG8_BAR; PG8_SCHED;
            PG8_LDB(B0, 1, 0); PG8_LDB(B1, 1, 1); PG8_SCHED; PG8_LDA(At, 1, 0); PG8_STAGE(PG8_SA(0, 1), a2 + hstep, voffA);
            PG8_WAIT_V(8); PG8_WAIT_L(0); PG8_BAR; PG8_MMA(0, 0, At, B0); PG8_MMA(0, 1, At, B1); PG8_BAR; PG8_SCHED;
            PG8_LDA(At, 1, 1); PG8_STAGE(PG8_SB(1, 0), b3, voffB); PG8_STAGE(PG8_SB(1, 1), b3 + hstep, voffB); PG8_STAGE(PG8_SA(1, 0), a3, voffA);
            PG8_WAIT_V(8); PG8_WAIT_L(0); PG8_BAR; PG8_MMA(1, 0, At, B0); PG8_MMA(1, 1, At, B1); PG8_BAR; PG8_SCHED;
            } else {
            PG8_LDB(B0, 0, 0); PG8_SCHED; PG8_LDA(At, 0, 0); PG8_STAGE(PG8_SA(1, 1), a1 + hstep, voffA);
            PG8_WAIT_L(8); PG8_BAR; PG8_WAIT_L(0); PG8_MMA(0, 0, At, B0); PG8_BAR; PG8_SCHED;
            PG8_LDB(B1, 0, 1); PG8_STAGE(PG8_SB(0, 0), b2, voffB);
            PG8_BAR; PG8_WAIT_L(0); PG8_MMA(0, 1, At, B1); PG8_BAR;
            PG8_LDA(At, 0, 1); PG8_STAGE(PG8_SA(0, 0), a2, voffA);
            PG8_BAR; PG8_WAIT_L(0); PG8_MMA(1, 0, At, B0); PG8_BAR; PG8_SCHED;
            PG8_STAGE(PG8_SB(0, 1), b2 + hstep, voffB);
            PG8_WAIT_V(6); PG8_BAR; PG8_MMA(1, 1, At, B1); PG8_BAR;
            PG8_LDB(B0, 1, 0); PG8_SCHED; PG8_LDA(At, 1, 0); PG8_STAGE(PG8_SA(0, 1), a2 + hstep, voffA);
            PG8_WAIT_L(8); PG8_BAR; PG8_WAIT_L(0); PG8_MMA(0, 0, At, B0); PG8_BAR; PG8_SCHED;
            PG8_LDB(B1, 1, 1); PG8_STAGE(PG8_SB(1, 0), b3, voffB);
            PG8_BAR; PG8_WAIT_L(0); PG8_MMA(0, 1, At, B1); PG8_BAR;
            PG8_LDA(At, 1, 1); PG8_STAGE(PG8_SA(1, 0), a3, voffA);
            PG8_BAR; PG8_WAIT_L(0); PG8_MMA(1, 0, At, B0); PG8_BAR; PG8_SCHED;
            PG8_STAGE(PG8_SB(1, 1), b3 + hstep, voffB);
            PG8_WAIT_V(6); PG8_BAR; PG8_MMA(1, 1, At, B1); PG8_BAR;
            }
        }
        if constexpr (ALIGN_EPI) { if (wr == 0) PG8_BAR; }
        if constexpr (!Epi::AFTER_DRAIN) { E(acc, cur, wr, wc, fr, fq); S.done(cur); }
        if (!has_next) break;
#pragma unroll
        for (int a = 0; a < 2; ++a)
#pragma unroll
            for (int b = 0; b < 2; ++b)
#pragma unroll
                for (int m = 0; m < 4; ++m)
#pragma unroll
                    for (int n = 0; n < 2; ++n) acc[a][b][m][n] = (f32x4){0.f, 0.f, 0.f, 0.f};
        cur = nxt; cA = nA; cB = nB; ++ui;
        if constexpr (ALIGN_EPI) { if (wr == 1) PG8_BAR; }
    }
    PG8_WAIT_V(0);
    if constexpr (!ALIGN_EPI) { if (wr == 0) PG8_BAR; }
    PG8_BAR;
    if constexpr (Epi::AFTER_DRAIN) { E.fused(acc, cur, wr, wc, fr, fq, lds, wid, lane); S.done(cur); }
#undef PG8_SA
#undef PG8_SB
#undef PG8_STAGE
#undef PG8_LDA
#undef PG8_LDB
#undef PG8_MMA
#undef PG8_WAIT_V
#undef PG8_WAIT_L
#undef PG8_BAR
#undef PG8_SCHED
}
}

constexpr int S = 8192, DM = 2048, DEPTH = 4, CA = 512, CB = 1024, CC = 512, NH = 16, HD = 64, INW = 4608, FFH = 5632, CONVW = 31;
constexpr float EPS = 1e-6f;
constexpr int NWAVES = 8;

constexpr size_t MiB = 1u << 20;
constexpr size_t WS_CTL = 0, CTL_ZERO_BYTES = 65536;
constexpr size_t WS_W = 1 * MiB;
constexpr size_t WO_IN = 0, WO_OUT = 18 * MiB, WO_GU = 26 * MiB, WO_DN = 70 * MiB, LAYER_W = 92 * MiB;
constexpr size_t WS_H = 369 * MiB;
constexpr size_t WS_GLU = 401 * MiB;
constexpr size_t WS_QKV = 409 * MiB;
constexpr size_t WS_POOL = 457 * MiB;
constexpr size_t WS_OP = 465 * MiB;
constexpr size_t WS_LSE = 513 * MiB;
constexpr size_t WS_Y = 515 * MiB;
constexpr size_t WS_Z = 547 * MiB;
constexpr size_t WS_HID = 401 * MiB;
constexpr size_t WS_ROPE = 579 * MiB;
constexpr size_t WS_FOLD = 580 * MiB;
constexpr size_t WS_END = 596 * MiB;
static_assert(WS_HID + (size_t)S * FFH * 2 <= WS_Y, "hid overlay");
constexpr int CW_BAR = 1024;

constexpr int LDS_BYTES = 147456;
constexpr int MISC_OFF = 143360;
constexpr int PHASE_LDS = 143360;

#ifndef GEMM_ALIGN
#define GEMM_ALIGN true
#endif
#ifndef GEMM_SP2
#define GEMM_SP2 true
#endif
#define GAS __attribute__((address_space(1)))
#define LAS __attribute__((address_space(3)))
typedef unsigned short bf16;
typedef unsigned v4u __attribute__((ext_vector_type(4)));
typedef float f32x4 __attribute__((ext_vector_type(4)));
typedef short bf16x8 __attribute__((ext_vector_type(8)));
typedef GAS unsigned gu32;
typedef GAS unsigned long long gu64;
#define RLX_AGENT __ATOMIC_RELAXED, __HIP_MEMORY_SCOPE_AGENT
#define LDS_WAIT() asm volatile("s_waitcnt lgkmcnt(0)" ::: "memory")
#define VM_WAIT() asm volatile("s_waitcnt vmcnt(0)" ::: "memory")
__device__ __forceinline__ unsigned long long rt() { return __builtin_amdgcn_s_memrealtime(); }
__device__ __forceinline__ unsigned f2bf(float f) { unsigned u = __builtin_bit_cast(unsigned, f); return (u + 0x7fffu + ((u >> 16) & 1u)) >> 16; }
__device__ __forceinline__ unsigned pk2(float lo, float hi) { return f2bf(lo) | (f2bf(hi) << 16); }

#define XB_TMO      128
#define XB_XCNT(j)  (256  + 64 * (j))
#define XB_XSUB(j)  (1280 + 64 * (j))
#define XB_XGEN(j)  (2304 + 64 * (j))
#define XB_TOP      3328
#define XB_TOPGEN   3392
#define XCD_BAR_WORDS 3456
#define XB_SPIN_CAP (1u << 18)

__device__ __forceinline__ unsigned xb_ld(unsigned* p)              { return __hip_atomic_load(p, __ATOMIC_RELAXED, __HIP_MEMORY_SCOPE_AGENT); }
__device__ __forceinline__ unsigned xb_add(unsigned* p, unsigned v) { return __hip_atomic_fetch_add(p, v, __ATOMIC_RELAXED, __HIP_MEMORY_SCOPE_AGENT); }
__device__ __forceinline__ unsigned xb_xcc_id() { return (unsigned)__builtin_amdgcn_s_getreg((3 << 11) | 20) & 0xFu; }
#define XB_SPIN(cond, bar) do { unsigned _sp = 0; while (cond) { __builtin_amdgcn_s_sleep(1); \
    if ((++_sp & 255u) == 0u) { if (xb_ld(&(bar)[XB_TMO])) break; if (_sp > XB_SPIN_CAP) { atomicAdd(&(bar)[XB_TMO], 1u); break; } } } } while (0)

struct XcdBarrier {
    unsigned* bar; unsigned x;
    volatile LAS unsigned* st;
};

__device__ __forceinline__ XcdBarrier xcd_barrier_post(unsigned* bar, volatile LAS unsigned* st) {
    XcdBarrier b; b.bar = bar; b.x = xb_xcc_id(); b.st = st;
    if (threadIdx.x == 0) (void)xb_add(&bar[XB_XCNT(b.x)], 1u);
    return b;
}
__device__ __forceinline__ void xcd_barrier_complete(unsigned* bar, unsigned x, unsigned& nloc, unsigned& nx) {
    const unsigned G = gridDim.x * gridDim.y * gridDim.z;
    unsigned sum, cnt, mine, sp = 0u;
    for (;;) {
        sum = 0u; cnt = 0u; mine = 0u;
#pragma unroll
        for (unsigned j = 0; j < 16; ++j) { const unsigned c = xb_ld(&bar[XB_XCNT(j)]); sum += c; cnt += (c > 0u) ? 1u : 0u; mine = (j == x) ? c : mine; }
        if (sum == G) break;
        __builtin_amdgcn_s_sleep(1);
        if ((++sp & 255u) == 0u) { if (xb_ld(&bar[XB_TMO])) break; if (sp > XB_SPIN_CAP) { atomicAdd(&bar[XB_TMO], 1u); break; } }
    }
    nloc = mine > 0u ? mine : 1u; nx = cnt > 0u ? cnt : 1u;
}

__device__ __forceinline__ void xcd_barrier(const XcdBarrier& b, const int tid0  ) {
    asm volatile("s_waitcnt vmcnt(0)" ::: "memory");
    __syncthreads();
    if (tid0 == 0) {
        unsigned* bar = b.bar;
        __builtin_amdgcn_s_waitcnt(0);
        unsigned nloc = b.st[0], nx = b.st[1];
        if (nloc == 0u) { xcd_barrier_complete(bar, b.x, nloc, nx); b.st[0] = nloc; b.st[1] = nx; }
        const unsigned old = xb_add(&bar[XB_XSUB(b.x)], 1u);
        const unsigned gen = old / nloc;
        if (old + 1u == (gen + 1u) * nloc) {
            __builtin_amdgcn_fence(__ATOMIC_RELEASE, "agent");
            asm volatile("s_waitcnt vmcnt(0)" ::: "memory");
            const unsigned og = xb_add(&bar[XB_TOP], 1u);
            const unsigned tg = og / nx;
            if (og + 1u == (tg + 1u) * nx) xb_add(&bar[XB_TOPGEN], 1u);
            else XB_SPIN(xb_ld(&bar[XB_TOPGEN]) == tg, bar);
            __builtin_amdgcn_fence(__ATOMIC_ACQUIRE, "agent");
            xb_add(&bar[XB_XGEN(b.x)], 1u);
            asm volatile("s_waitcnt vmcnt(0)" ::: "memory");
        } else {
            XB_SPIN(xb_ld(&bar[XB_XGEN(b.x)]) == gen, bar);
            __builtin_amdgcn_fence(__ATOMIC_ACQUIRE, "agent");
            asm volatile("s_waitcnt vmcnt(0)" ::: "memory");
        }
    }
    __syncthreads();
}

typedef short s16x4 __attribute__((ext_vector_type(4)));
typedef float f32x16 __attribute__((ext_vector_type(16)));
struct Frame {
    LAS unsigned char* lds;
    volatile LAS unsigned* MISC;
    gu32* ctl;
    int tid, lane, wave;
    int vcu, G, gw, NGW, bx;
};
__device__ __forceinline__ float wave_sum(float v) {
    v += pg8::shx<1>(v); v += pg8::shx<2>(v); v += pg8::shx<4>(v); v += pg8::shx<8>(v); v += pg8::shx<16>(v);
    return pg8::sum32(v);
}
__device__ __forceinline__ f32x4 ldf4(const float* p) { return *(const f32x4*)p; }
__device__ __forceinline__ void bf8_to_f32(const v4u w, float (&f)[8]) {
    f[0] = __uint_as_float(w.x << 16); f[1] = __uint_as_float(w.x & 0xffff0000u); f[2] = __uint_as_float(w.y << 16); f[3] = __uint_as_float(w.y & 0xffff0000u);
    f[4] = __uint_as_float(w.z << 16); f[5] = __uint_as_float(w.z & 0xffff0000u); f[6] = __uint_as_float(w.w << 16); f[7] = __uint_as_float(w.w & 0xffff0000u);
}
__device__ __forceinline__ v4u f32_to_bf8(const float (&f)[8]) { v4u o; o.x = pg8::cvt_pk_bf16(f[0], f[1]); o.y = pg8::cvt_pk_bf16(f[2], f[3]); o.z = pg8::cvt_pk_bf16(f[4], f[5]); o.w = pg8::cvt_pk_bf16(f[6], f[7]); return o; }

__device__ __forceinline__ void transpose_item(const float* W, int ldw, int k0, int n0, bf16* WT, int K, int drow, LAS float* scr, int lane) {
#pragma unroll 8
    for (int i = 0; i < 32; ++i) { const int kk = 2 * i + (lane >> 5); scr[kk * 33 + (lane & 31)] = W[(size_t)(k0 + kk) * ldw + n0 + (lane & 31)]; }
    LDS_WAIT(); asm volatile("" ::: "memory");
    const int c = lane & 7;
#pragma unroll
    for (int j = 0; j < 4; ++j) { const int n = (lane >> 3) + 8 * j; const LAS float* s = scr + (8 * c) * 33 + n;
        v4u o; o.x = pk2(s[0 * 33], s[1 * 33]); o.y = pk2(s[2 * 33], s[3 * 33]); o.z = pk2(s[4 * 33], s[5 * 33]); o.w = pk2(s[6 * 33], s[7 * 33]);
        *(GAS v4u*)(WT + (size_t)(drow + n) * K + k0 + 8 * c) = o; }
    LDS_WAIT(); asm volatile("" ::: "memory");
}
__device__ __forceinline__ int gated_row(int c, int gate) { return (c >> 7) * 256 + (c & 127) + gate * 128; }

__device__ __forceinline__ void rms_row_to_bf16(const float* xrow, const float* g, bf16* orow, int lane) {
    f32x4 v[8]; float ss = 0.f;
#pragma unroll
    for (int j = 0; j < 4; ++j) { v[2 * j] = ldf4(xrow + 512 * j + 8 * lane); v[2 * j + 1] = ldf4(xrow + 512 * j + 8 * lane + 4); }
#pragma unroll
    for (int j = 0; j < 8; ++j) ss += (v[j].x * v[j].x + v[j].y * v[j].y) + (v[j].z * v[j].z + v[j].w * v[j].w);
    const float rstd = 1.0f / sqrtf(wave_sum(ss) * (1.0f / DM) + EPS);
#pragma unroll
    for (int j = 0; j < 4; ++j) { const f32x4 one4 = (f32x4){1.f, 1.f, 1.f, 1.f}; const f32x4 g0 = g ? ldf4(g + 512 * j + 8 * lane) : one4, g1 = g ? ldf4(g + 512 * j + 8 * lane + 4) : one4; const f32x4 a = v[2 * j] * rstd * g0, b = v[2 * j + 1] * rstd * g1;
        v4u o; o.x = pg8::cvt_pk_bf16(a.x, a.y); o.y = pg8::cvt_pk_bf16(a.z, a.w); o.z = pg8::cvt_pk_bf16(b.x, b.y); o.w = pg8::cvt_pk_bf16(b.z, b.w);
        *(GAS v4u*)(orow + 512 * j + 8 * lane) = o; }
}

struct Ptrs {
    const float *x, *w_in, *conv_w, *conv_b, *conv_ln_g, *conv_ln_b, *pool_w, *pool_scale, *g_mix, *w_out, *g_pre_mix, *g_post_mix, *g_pre_ffn, *g_post_ffn, *w_gate, *w_up, *w_down;
    float* out; unsigned char* ws;
};
__device__ __forceinline__ unsigned long long karg_u64(int off) { return *(volatile const __attribute__((address_space(4))) unsigned long long*)((const __attribute__((address_space(4))) unsigned char*)__builtin_amdgcn_kernarg_segment_ptr() + off); }
#define KF(field) P.field = (const float*)(const GAS float*)karg_u64((int)offsetof(Ptrs, field))
__device__ __forceinline__ Ptrs load_ptrs() {
    Ptrs P; KF(x); KF(w_in); KF(conv_w); KF(conv_b); KF(conv_ln_g); KF(conv_ln_b); KF(pool_w); KF(pool_scale); KF(g_mix); KF(w_out); KF(g_pre_mix); KF(g_post_mix); KF(g_pre_ffn); KF(g_post_ffn); KF(w_gate); KF(w_up); KF(w_down);
    P.out = (float*)(GAS float*)karg_u64((int)offsetof(Ptrs, out)); P.ws = (unsigned char*)(GAS unsigned char*)karg_u64((int)offsetof(Ptrs, ws)); return P;
}
#undef KF

__device__ __forceinline__ void p0a(Frame& F, const Ptrs& P) {
    const int lane = F.lane;
    float* fold = (float*)(P.ws + WS_FOLD);
    for (int it = F.gw; it < DEPTH * 4 * 256; it += F.NGW) {
        const int l = it >> 10, gi = (it >> 8) & 3, k0 = (it & 255) * 8;
        const float* A = P.w_in + ((size_t)l * DM + k0) * INW + 4096 + gi * 128;
        const float* Wp = P.pool_w + ((size_t)(l * 4 + gi) * 128) * 128;
        float a0[8], a1[8], acc0[8], acc1[8];
#pragma unroll
        for (int kk = 0; kk < 8; ++kk) { a0[kk] = A[(size_t)kk * INW + lane]; a1[kk] = A[(size_t)kk * INW + 64 + lane]; acc0[kk] = 0.f; acc1[kk] = 0.f; }
#pragma unroll 4
        for (int c = 0; c < 64; ++c) { const float w0 = Wp[c * 128 + lane], w1 = Wp[c * 128 + 64 + lane];
#pragma unroll
            for (int kk = 0; kk < 8; ++kk) { const float s = __builtin_bit_cast(float, __builtin_amdgcn_readlane(__builtin_bit_cast(int, a0[kk]), c)); acc0[kk] += s * w0; acc1[kk] += s * w1; } }
#pragma unroll 4
        for (int c = 0; c < 64; ++c) { const float w0 = Wp[(64 + c) * 128 + lane], w1 = Wp[(64 + c) * 128 + 64 + lane];
#pragma unroll
            for (int kk = 0; kk < 8; ++kk) { const float s = __builtin_bit_cast(float, __builtin_amdgcn_readlane(__builtin_bit_cast(int, a1[kk]), c)); acc0[kk] += s * w0; acc1[kk] += s * w1; } }
        const float sc0 = P.pool_scale[l * CC + gi * 128 + lane], sc1 = P.pool_scale[l * CC + gi * 128 + 64 + lane];
        float* o = fold + ((size_t)l * DM + k0) * CC + gi * 128;
#pragma unroll
        for (int kk = 0; kk < 8; ++kk) { o[(size_t)kk * CC + lane] = acc0[kk] * sc0; o[(size_t)kk * CC + 64 + lane] = acc1[kk] * sc1; }
    }
    {
        float* rope = (float*)(P.ws + WS_ROPE);
        const int gt = F.gw * 64 + lane, NT = F.NGW * 64;
        for (int e = gt; e < S * 8; e += NT) { const int pos = e >> 3, i = e & 7;
            const float invf = i == 0 ? 1.0f : i == 1 ? 0.1939227432012558f : i == 2 ? 0.03760603070259094f : i == 3 ? 0.007292664609849453f : i == 4 ? 0.0014142135623842478f : i == 5 ? 0.00027424818836152554f : i == 6 ? 5.318296098266728e-05f : 1.0313386155758053e-05f;
            const float angf = (float)pos * invf; const double ang = (double)angf;
            const double kq = __builtin_rint(ang * 0.63661977236758134308); const double rr = __builtin_fma(-kq, 1.57079632679489655800, ang) - kq * 6.123233995736766e-17;
            const double r2 = rr * rr;
            const double sn = rr * (1.0 + r2 * (-1.0 / 6 + r2 * (1.0 / 120 + r2 * (-1.0 / 5040 + r2 * (1.0 / 362880 + r2 * (-1.0 / 39916800 + r2 * (1.0 / 6227020800.0)))))));
            const double cn = 1.0 + r2 * (-0.5 + r2 * (1.0 / 24 + r2 * (-1.0 / 720 + r2 * (1.0 / 40320 + r2 * (-1.0 / 3628800 + r2 * (1.0 / 479001600.0 + r2 * (-1.0 / 87178291200.0)))))));
            const int q = ((int)kq) & 3; const double sv = q == 0 ? sn : q == 1 ? cn : q == 2 ? -sn : -cn, cv = q == 0 ? cn : q == 1 ? -sn : q == 2 ? -cn : sn;
            rope[pos * 16 + i] = (float)cv; rope[pos * 16 + 8 + i] = (float)sv; }
    }
    bf16* H = (bf16*)(P.ws + WS_H);
    for (int m = F.gw; m < S; m += F.NGW) rms_row_to_bf16(P.x + (size_t)m * DM,
#ifdef NO_GPM
        nullptr,
#else
        P.g_pre_mix,
#endif
        H + (size_t)m * DM, lane);
}
__device__ __forceinline__ void p0b(Frame& F, const Ptrs& P) {
    LAS float* scr = (LAS float*)(F.lds + F.wave * 16384);
    constexpr int IA = 32 * 128, IB = 32 * 16, IC = 32 * 64, ID = 32 * 176, IE = ID, IF_ = 88 * 64, IL = IA + IB + IC + ID + IE + IF_;
    for (int it = F.gw; it < DEPTH * IL; it += F.NGW) {
        const int l = it / IL; int r = it - l * IL;
        unsigned char* wl = P.ws + WS_W + (size_t)l * LAYER_W;
        if (r < IA) { const int kb = r >> 7, nb = r & 127, n0 = nb * 32; const int drow = n0 < 512 ? gated_row(n0, 0) : n0 < 1024 ? gated_row(n0 - 512, 1) : n0;
            transpose_item(P.w_in + (size_t)l * DM * INW, INW, kb * 64, n0, (bf16*)(wl + WO_IN), DM, drow, scr, F.lane); continue; } r -= IA;
        if (r < IB) { const int kb = r >> 4, nb = r & 15;
#ifdef ALT_POOL
            transpose_item(P.w_in + (size_t)l * DM * INW, INW, kb * 64, 4096 + nb * 32, (bf16*)(wl + WO_IN), DM, 4096 + nb * 32, scr, F.lane); continue; } r -= IB;
#else
            transpose_item((const float*)(P.ws + WS_FOLD) + (size_t)l * DM * CC, CC, kb * 64, nb * 32, (bf16*)(wl + WO_IN), DM, 4096 + nb * 32, scr, F.lane); continue; } r -= IB;
#endif
        if (r < IC) { const int kb = r >> 6, nb = r & 63;
            transpose_item(P.w_out + (size_t)l * DM * DM, DM, kb * 64, nb * 32, (bf16*)(wl + WO_OUT), DM, nb * 32, scr, F.lane); continue; } r -= IC;
        if (r < ID) { const int kb = r / 176, nb = r % 176;
            transpose_item(P.w_gate + (size_t)l * DM * FFH, FFH, kb * 64, nb * 32, (bf16*)(wl + WO_GU), DM, gated_row(nb * 32, 1), scr, F.lane); continue; } r -= ID;
        if (r < IE) { const int kb = r / 176, nb = r % 176;
            transpose_item(P.w_up + (size_t)l * DM * FFH, FFH, kb * 64, nb * 32, (bf16*)(wl + WO_GU), DM, gated_row(nb * 32, 0), scr, F.lane); continue; } r -= IE;
        { const int kb = r >> 6, nb = r & 63;
            transpose_item(P.w_down + (size_t)l * FFH * DM, DM, kb * 64, nb * 32, (bf16*)(wl + WO_DN), FFH, nb * 32, scr, F.lane); }
    }
}

namespace att {
constexpr int NKEY = 384, K_OFF = 0, V_OFF = NKEY * 128, VH_STRIDE = NKEY * 64 + 64, WS_OFF = V_OFF + 2 * VH_STRIDE, OST_OFF = WS_OFF + 2048, ATT_LDS = OST_OFF + 8 * 4096;
static_assert(ATT_LDS <= PHASE_LDS, "attention LDS");
__device__ __forceinline__ int crow(int r, int hi) { return (r & 3) + 8 * (r >> 2) + 4 * hi; }
typedef short v4i16_t __attribute__((ext_vector_type(4)));
__device__ __forceinline__ s16x4 vtr(LAS const unsigned char* p) { return __builtin_bit_cast(s16x4, __builtin_amdgcn_ds_read_tr16_b64_v4i16((LAS v4i16_t*)p)); }
__device__ __forceinline__ void unit(const bf16* qkv, bf16* op, float* lse, int d, int L, int h, int r, int j0, LAS unsigned char* lds, int tid, int wid, int lane) {
    v4u kv[6], vv[6];
#pragma unroll
    for (int i = 0; i < 6; ++i) { const int p = tid + 512 * i, key = p >> 3, c = p & 7, j = j0 - 64 + key;
        kv[i] = (v4u){0u, 0u, 0u, 0u}; vv[i] = (v4u){0u, 0u, 0u, 0u};
        if (j >= 0 && j < L) { const bf16* src = qkv + (size_t)(j * d + r) * 3072 + h * 64 + c * 8; kv[i] = *(const GAS v4u*)(src + 1024); vv[i] = *(const GAS v4u*)(src + 2048); } }
    const int r32 = lane & 31, hi = lane >> 5;
    const int jq = j0 + 32 * wid + r32;
    pg8::bf16x8 qf[4];
    { const bf16* qp = qkv + (size_t)(jq * d + r) * 3072 + h * 64 + hi * 8;
#pragma unroll
      for (int d0 = 0; d0 < 4; ++d0) qf[d0] = *(const GAS pg8::bf16x8*)(qp + 16 * d0); }
#pragma unroll
    for (int i = 0; i < 6; ++i) { const int p = tid + 512 * i, key = p >> 3, c = p & 7;
        *(LAS v4u*)(lds + K_OFF + key * 128 + ((c ^ ((key >> 1) & 7)) << 4)) = kv[i];
        *(LAS v4u*)(lds + V_OFF + (c >> 2) * VH_STRIDE + key * 64 + (c & 3) * 16) = vv[i]; }
    __syncthreads();
    f32x16 s[5];
#pragma unroll
    for (int kt = 0; kt < 5; ++kt) { const int key = 32 * wid + 32 * kt + r32;
#pragma unroll
        for (int e = 0; e < 16; ++e) s[kt][e] = 0.f;
#pragma unroll
        for (int d0 = 0; d0 < 4; ++d0) { const int c = 2 * d0 + hi; const pg8::bf16x8 a = *(LAS const pg8::bf16x8*)(lds + K_OFF + key * 128 + ((c ^ ((key >> 1) & 7)) << 4));
            s[kt] = __builtin_amdgcn_mfma_f32_32x32x16_bf16(a, qf[d0], s[kt], 0, 0, 0); } }
    const float NEGINF = -__builtin_inff();
#pragma unroll
    for (int e = 0; e < 16; ++e) { const int cr = crow(e, hi); if (cr < r32) s[0][e] = NEGINF; if (cr > r32) s[4][e] = NEGINF; }
    const int kb_lo = 64 - j0, kb_hi = L - j0 + 64;
    if (kb_lo > 0 || kb_hi < NKEY) {
#pragma unroll
        for (int kt = 0; kt < 5; ++kt)
#pragma unroll
            for (int e = 0; e < 16; ++e) { const int kb = 32 * wid + 32 * kt + crow(e, hi); if (kb < kb_lo || kb >= kb_hi) s[kt][e] = NEGINF; } }
    float mx = NEGINF;
#pragma unroll
    for (int kt = 0; kt < 5; ++kt)
#pragma unroll
        for (int e = 0; e < 16; ++e) mx = fmaxf(mx, s[kt][e]);
    mx = pg8::max32(mx);
    float l = 0.f;
#pragma unroll
    for (int kt = 0; kt < 5; ++kt)
#pragma unroll
        for (int e = 0; e < 16; ++e) { const float p = __builtin_amdgcn_exp2f(s[kt][e] - mx); s[kt][e] = p; l += p; }
    l = pg8::sum32(l);
    f32x16 o[2];
#pragma unroll
    for (int e = 0; e < 16; ++e) { o[0][e] = 0.f; o[1][e] = 0.f; }
    LAS const unsigned char* vbase = lds + V_OFF + (32 * wid + 4 * hi + ((lane & 15) >> 2)) * 64 + ((lane >> 4) & 1) * 32 + (lane & 3) * 8;
#pragma unroll
    for (int kt = 0; kt < 5; ++kt)
#pragma unroll
        for (int s2 = 0; s2 < 2; ++s2) {
            v4u pw; pw.x = pg8::cvt_pk_bf16(s[kt][8 * s2 + 0], s[kt][8 * s2 + 1]); pw.y = pg8::cvt_pk_bf16(s[kt][8 * s2 + 2], s[kt][8 * s2 + 3]);
            pw.z = pg8::cvt_pk_bf16(s[kt][8 * s2 + 4], s[kt][8 * s2 + 5]); pw.w = pg8::cvt_pk_bf16(s[kt][8 * s2 + 6], s[kt][8 * s2 + 7]);
            const pg8::bf16x8 pa = __builtin_bit_cast(pg8::bf16x8, pw);
#pragma unroll
            for (int db = 0; db < 2; ++db) { LAS const unsigned char* vp = vbase + db * VH_STRIDE + (32 * kt + 16 * s2) * 64;
                const s16x4 lo = vtr(vp), hh = vtr(vp + 512);
                const pg8::bf16x8 vb = (pg8::bf16x8){lo[0], lo[1], lo[2], lo[3], hh[0], hh[1], hh[2], hh[3]};
                o[db] = __builtin_amdgcn_mfma_f32_32x32x16_bf16(pa, vb, o[db], 0, 0, 0); } }
    LAS float* wsf = (LAS float*)(lds + WS_OFF) + wid * 64;
    if (hi == 0) wsf[r32] = l;
    asm volatile("s_waitcnt lgkmcnt(0)" ::: "memory");
    LAS bf16* stg = (LAS bf16*)(lds + OST_OFF) + wid * 2048;
#pragma unroll
    for (int e = 0; e < 16; ++e) { const int q = crow(e, hi); const float rl = __builtin_amdgcn_rcpf(wsf[q]);
        stg[q * 64 + r32] = (bf16)f2bf(o[0][e] * rl); stg[q * 64 + 32 + r32] = (bf16)f2bf(o[1][e] * rl); }
    asm volatile("s_waitcnt lgkmcnt(0)" ::: "memory");
#pragma unroll
    for (int i = 0; i < 4; ++i) { const int row = i * 8 + (lane >> 3), ch = lane & 7; const v4u v = *(LAS const v4u*)(stg + row * 64 + ch * 8);
        *(GAS v4u*)(op + (size_t)((j0 + 32 * wid + row) * d + r) * 1024 + h * 64 + ch * 8) = v; }
    if (hi == 0) lse[(size_t)(jq * d + r) * 16 + h] = mx + __builtin_amdgcn_logf(l);
    __syncthreads();
}
}

#ifdef NAIVE_ATT
__device__ __forceinline__ void attn_phase(Frame& F, const Ptrs& P) {
    const bf16* qkv = (const bf16*)(P.ws + WS_QKV);
    const int gt = F.vcu * 512 + F.tid; const int t = gt >> 4, h = gt & 15;
    float q[64], o[64];
    { const bf16* qp = qkv + (size_t)t * 3072 + h * 64;
#pragma unroll
      for (int c = 0; c < 8; ++c) { float f[8]; bf8_to_f32(*(const GAS v4u*)(qp + 8 * c), f);
#pragma unroll
        for (int j = 0; j < 8; ++j) { q[8 * c + j] = f[j]; o[8 * c + j] = 0.f; } } }
#ifdef ALT_ROPE
    const float* ropet = (const float*)(P.ws + WS_ROPE);
    { const float* cs = ropet + (size_t)t * 16;
#pragma unroll
      for (int i = 0; i < 8; ++i) { const float a = q[i], b = q[8 + i]; q[i] = a * cs[i] - b * cs[8 + i]; q[8 + i] = b * cs[i] + a * cs[8 + i]; } }
#endif
    float mx = -1e30f, l = 0.f;
    for (int p = 0; p < 3; ++p) { const int d = 1 << (2 * p);
        for (int m = -64; m <= 64; ++m) { const int pos = t + m * d; if (pos < 0 || pos >= S) continue;
            const bf16* kp = qkv + (size_t)pos * 3072 + 1024 + h * 64; float s = 0.f;
#ifdef ALT_ROPE
            { float k0[8], k1[8]; bf8_to_f32(*(const GAS v4u*)(kp), k0); bf8_to_f32(*(const GAS v4u*)(kp + 8), k1); const float* cs = ropet + (size_t)pos * 16;
#pragma unroll
              for (int i = 0; i < 8; ++i) { const float a = k0[i], b = k1[i]; s += q[i] * (a * cs[i] - b * cs[8 + i]) + q[8 + i] * (b * cs[i] + a * cs[8 + i]); } }
#pragma unroll
            for (int c = 2; c < 8; ++c) { float f[8]; bf8_to_f32(*(const GAS v4u*)(kp + 8 * c), f);
#pragma unroll
                for (int j = 0; j < 8; ++j) s += q[8 * c + j] * f[j]; }
#else
#pragma unroll
            for (int c = 0; c < 8; ++c) { float f[8]; bf8_to_f32(*(const GAS v4u*)(kp + 8 * c), f);
#pragma unroll
                for (int j = 0; j < 8; ++j) s += q[8 * c + j] * f[j]; }
#endif
            const float nm = fmaxf(mx, s), al = __builtin_amdgcn_exp2f(mx - nm), pe = __builtin_amdgcn_exp2f(s - nm); mx = nm; l = l * al + pe;
#pragma unroll
            for (int c = 0; c < 8; ++c) { float f[8]; bf8_to_f32(*(const GAS v4u*)(kp + 1024 + 8 * c), f);
#pragma unroll
                for (int j = 0; j < 8; ++j) o[8 * c + j] = o[8 * c + j] * al + pe * f[j]; } } }
    const float il = 1.0f / l;
    bf16* op = (bf16*)(P.ws + WS_OP); float* lse = (float*)(P.ws + WS_LSE);
#pragma unroll
    for (int c = 0; c < 8; ++c) { float f[8];
#pragma unroll
        for (int j = 0; j < 8; ++j) f[j] = o[8 * c + j] * il;
        *(GAS v4u*)(op + (size_t)t * CB + h * 64 + 8 * c) = f32_to_bf8(f);
        *(GAS v4u*)(op + ((size_t)S + t) * CB + h * 64 + 8 * c) = (v4u){0u, 0u, 0u, 0u}; *(GAS v4u*)(op + ((size_t)2 * S + t) * CB + h * 64 + 8 * c) = (v4u){0u, 0u, 0u, 0u}; }
    lse[(size_t)t * NH + h] = 0.f; lse[((size_t)S + t) * NH + h] = -1e9f; lse[((size_t)2 * S + t) * NH + h] = -1e9f;
}
#else
__device__ __forceinline__ void attn_phase(Frame& F, const Ptrs& P) {
    const bf16* qkv = (const bf16*)(P.ws + WS_QKV);
    for (int u = F.vcu; u < 3 * NH * 32; u += F.G) {
        const int p = u >> 9, h = (u >> 5) & 15, idx = u & 31;
        const int sh = 2 * p, d = 1 << sh, L = S >> sh, nb = 32 >> sh;
        const int r = idx / nb, b = idx - r * nb;
        att::unit(qkv, (bf16*)(P.ws + WS_OP) + (size_t)p * S * CB, (float*)(P.ws + WS_LSE) + (size_t)p * S * NH, d, L, h, r, b * 256, F.lds, F.tid, F.wave, F.lane);
    }
}

#endif

__device__ __forceinline__ float siluf(float x) { return x * __builtin_amdgcn_rcpf(1.0f + __builtin_amdgcn_exp2f(-1.4426950408889634f * x)); }
__device__ __forceinline__ void mix_phase(Frame& F, const Ptrs& P, int l) {
    bf16* Y = (bf16*)(P.ws + WS_Y);
    const int lane = F.lane;
#ifdef ALT_CONV
    {
        const bf16* GLU = (const bf16*)(P.ws + WS_GLU);
        for (int t = F.gw; t < S; t += F.NGW) {
            float v[8];
#pragma unroll
            for (int j = 0; j < 8; ++j) v[j] = P.conv_b[l * CA + 8 * lane + j];
            for (int k = 0; k < CONVW; ++k) { const int row = t + k - 15; if (row < 0 || row >= S) continue;
                float g[8]; bf8_to_f32(*(const GAS v4u*)(GLU + (size_t)row * CA + 8 * lane), g);
                const float* wk = P.conv_w + ((size_t)l * CONVW + k) * CA + 8 * lane;
#pragma unroll
                for (int j = 0; j < 8; ++j) v[j] += wk[j] * g[j]; }
            float sm = 0.f;
#pragma unroll
            for (int j = 0; j < 8; ++j) sm += v[j];
            const float mu = wave_sum(sm) * (1.0f / CA); float sq = 0.f;
#pragma unroll
            for (int j = 0; j < 8; ++j) { v[j] -= mu; sq += v[j] * v[j]; }
            const float rstd = 1.0f / sqrtf(wave_sum(sq) * (1.0f / CA) + EPS);
            float ss = 0.f;
#pragma unroll
            for (int j = 0; j < 8; ++j) { v[j] = siluf(v[j] * rstd * P.conv_ln_g[l * CA + 8 * lane + j] + P.conv_ln_b[l * CA + 8 * lane + j]); ss += v[j] * v[j]; }
            const float r2 = 1.0f / sqrtf(wave_sum(ss) * (1.0f / CA) + EPS);
#pragma unroll
            for (int j = 0; j < 8; ++j) v[j] = v[j] * r2 * P.g_mix[l * DM + 8 * lane + j];
            *(GAS v4u*)(Y + (size_t)t * DM + 8 * lane) = f32_to_bf8(v);
        }
    }
#else
    {
        constexpr int TB = 32, NR = TB + 30;
        LAS bf16* gl = (LAS bf16*)F.lds;
        LAS float* cv = (LAS float*)(F.lds + 63488);
        const bf16* GLU = (const bf16*)(P.ws + WS_GLU);
        const int c = F.tid;
        float w[CONVW];
#pragma unroll
        for (int j = 0; j < CONVW; ++j) w[j] = P.conv_w[((size_t)l * CONVW + j) * CA + c];
        const float cb = P.conv_b[l * CA + c];
        for (int blk = F.vcu; blk < S / TB; blk += F.G) {
            const int t0 = blk * TB;
            for (int p = F.tid; p < NR * 64; p += 512) { const int row = p >> 6, ch = p & 63, t = t0 - 15 + row;
                v4u v = (v4u){0u, 0u, 0u, 0u}; if (t >= 0 && t < S) v = *(const GAS v4u*)(GLU + (size_t)t * CA + ch * 8);
                *(LAS v4u*)(gl + row * 512 + ch * 8) = v; }
            __syncthreads();
            float acc[TB];
#pragma unroll
            for (int t = 0; t < TB; ++t) acc[t] = cb;
#pragma unroll
            for (int i = 0; i < NR; ++i) { const float g = __uint_as_float((unsigned)gl[i * 512 + c] << 16);
#pragma unroll
                for (int t = 0; t < TB; ++t) if (i - t >= 0 && i - t < CONVW) acc[t] += w[i - t] * g; }
#pragma unroll
            for (int t = 0; t < TB; ++t) cv[t * 512 + c] = acc[t];
            __syncthreads();
#pragma unroll
            for (int tt = 0; tt < 4; ++tt) { const int t = F.wave * 4 + tt;
                const f32x4 a = *(LAS const f32x4*)(cv + t * 512 + 8 * lane), b = *(LAS const f32x4*)(cv + t * 512 + 8 * lane + 4);
                float v[8] = {a.x, a.y, a.z, a.w, b.x, b.y, b.z, b.w};
                float sm = 0.f;
#pragma unroll
                for (int j = 0; j < 8; ++j) sm += v[j];
                const float mu = wave_sum(sm) * (1.0f / CA); float sq = 0.f;
#pragma unroll
                for (int j = 0; j < 8; ++j) { v[j] -= mu; sq += v[j] * v[j]; }
                const float rstd = 1.0f / sqrtf(wave_sum(sq) * (1.0f / CA) + EPS);
                const f32x4 g0 = ldf4(P.conv_ln_g + l * CA + 8 * lane), g1 = ldf4(P.conv_ln_g + l * CA + 8 * lane + 4), b0 = ldf4(P.conv_ln_b + l * CA + 8 * lane), b1 = ldf4(P.conv_ln_b + l * CA + 8 * lane + 4);
                const float gg[8] = {g0.x, g0.y, g0.z, g0.w, g1.x, g1.y, g1.z, g1.w}, bb[8] = {b0.x, b0.y, b0.z, b0.w, b1.x, b1.y, b1.z, b1.w};
                float ss = 0.f;
#pragma unroll
                for (int j = 0; j < 8; ++j) { v[j] = siluf(v[j] * rstd * gg[j] + bb[j]); ss += v[j] * v[j]; }
                const float r2 = 1.0f / sqrtf(wave_sum(ss) * (1.0f / CA) + EPS);
                const f32x4 m0 = ldf4(P.g_mix + l * DM + 8 * lane), m1 = ldf4(P.g_mix + l * DM + 8 * lane + 4);
                const float mm[8] = {m0.x, m0.y, m0.z, m0.w, m1.x, m1.y, m1.z, m1.w};
#pragma unroll
                for (int j = 0; j < 8; ++j) v[j] = v[j] * r2 * mm[j];
                *(GAS v4u*)(Y + (size_t)(t0 + t) * DM + 8 * lane) = f32_to_bf8(v); }
            __syncthreads();
        }
    }
#endif
    const bf16* OP = (const bf16*)(P.ws + WS_OP); const float* LSE = (const float*)(P.ws + WS_LSE); const bf16* PL = (const bf16*)(P.ws + WS_POOL);
    for (int t = F.gw; t < S; t += F.NGW) {
        {   const int hd = lane >> 2; float lv[3], o[3][16];
#pragma unroll
            for (int p = 0; p < 3; ++p) { lv[p] = LSE[((size_t)p * S + t) * NH + hd];
                const bf16* src = OP + ((size_t)p * S + t) * CB + 16 * lane; float f0[8], f1[8]; bf8_to_f32(*(const GAS v4u*)src, f0); bf8_to_f32(*(const GAS v4u*)(src + 8), f1);
#pragma unroll
                for (int j = 0; j < 8; ++j) { o[p][j] = f0[j]; o[p][8 + j] = f1[j]; } }
            const float mxl = fmaxf(lv[0], fmaxf(lv[1], lv[2]));
            const float w0 = __builtin_amdgcn_exp2f(lv[0] - mxl), w1 = __builtin_amdgcn_exp2f(lv[1] - mxl), w2 = __builtin_amdgcn_exp2f(lv[2] - mxl);
            const float inv = 1.0f / (w0 + w1 + w2); float v[16], ss = 0.f;
#pragma unroll
            for (int j = 0; j < 16; ++j) { v[j] = (w0 * o[0][j] + w1 * o[1][j] + w2 * o[2][j]) * inv; ss += v[j] * v[j]; }
            const float rstd = 1.0f / sqrtf(wave_sum(ss) * (1.0f / CB) + EPS);
            const float* gm = P.g_mix + l * DM + CA + 16 * lane; float a[8], b[8];
#pragma unroll
            for (int j = 0; j < 8; ++j) { a[j] = v[j] * rstd * gm[j]; b[j] = v[8 + j] * rstd * gm[8 + j]; }
            bf16* dst = Y + (size_t)t * DM + CA + 16 * lane; *(GAS v4u*)dst = f32_to_bf8(a); *(GAS v4u*)(dst + 8) = f32_to_bf8(b);
        }
        {   const int gi = lane >> 4, half = 1 << gi, lo = t - half < 0 ? 0 : t - half, hi = t + half > S ? S : t + half;
            float sum[8], self[8];
#pragma unroll
            for (int j = 0; j < 8; ++j) sum[j] = 0.f;
            bf8_to_f32(*(const GAS v4u*)(PL + (size_t)t * CC + 8 * lane), self);
            for (int k = -8; k < 8; ++k) { const int row = t + k; if (row >= lo && row < hi) { float f[8]; bf8_to_f32(*(const GAS v4u*)(PL + (size_t)row * CC + 8 * lane), f);
#pragma unroll
                    for (int j = 0; j < 8; ++j) sum[j] += f[j]; } }
            const float ic = 1.0f / (float)(hi - lo); float v[8], ss = 0.f;
#ifdef ALT_POOL
            { float pl[8];
#pragma unroll
              for (int j = 0; j < 8; ++j) { pl[j] = sum[j] * ic - self[j]; v[j] = 0.f; }
              const float* Wp = P.pool_w + ((size_t)(l * 4 + gi) * 128) * 128; const int d0 = 8 * (lane & 15);
              for (int c = 0; c < 128; ++c) { const int sl = (lane & 48) + (c >> 3);
                  float pc = 0.f;
#pragma unroll
                  for (int j = 0; j < 8; ++j) { const float x = __shfl(pl[j], sl); if ((c & 7) == j) pc = x; }
#pragma unroll
                  for (int j = 0; j < 8; ++j) v[j] += pc * Wp[c * 128 + d0 + j]; }
#pragma unroll
              for (int j = 0; j < 8; ++j) { v[j] *= P.pool_scale[l * CC + 8 * lane + j]; ss += v[j] * v[j]; } }
#else
#pragma unroll
            for (int j = 0; j < 8; ++j) { v[j] = sum[j] * ic - self[j]; ss += v[j] * v[j]; }
#endif
            const float rstd = 1.0f / sqrtf(wave_sum(ss) * (1.0f / CC) + EPS);
            const float* gm = P.g_mix + l * DM + CA + CB + 8 * lane;
#pragma unroll
            for (int j = 0; j < 8; ++j) v[j] = v[j] * rstd * gm[j];
            *(GAS v4u*)(Y + (size_t)t * DM + CA + CB + 8 * lane) = f32_to_bf8(v);
        }
    }
}

__device__ __forceinline__ void norm_res_phase(Frame& F, const Ptrs& P, const float* xs, const float* gpost, const float* gnext, const bool unit_next = false) {
    const bf16* Z = (const bf16*)(P.ws + WS_Z); bf16* H = (bf16*)(P.ws + WS_H); const int lane = F.lane;
    for (int m = F.gw; m < S; m += F.NGW) {
        float z[4][8], x[4][8]; float ss = 0.f;
#pragma unroll
        for (int j = 0; j < 4; ++j) { bf8_to_f32(*(const GAS v4u*)(Z + (size_t)m * DM + 512 * j + 8 * lane), z[j]);
            const f32x4 a = ldf4(xs + (size_t)m * DM + 512 * j + 8 * lane), b = ldf4(xs + (size_t)m * DM + 512 * j + 8 * lane + 4);
            x[j][0] = a.x; x[j][1] = a.y; x[j][2] = a.z; x[j][3] = a.w; x[j][4] = b.x; x[j][5] = b.y; x[j][6] = b.z; x[j][7] = b.w;
#pragma unroll
            for (int e = 0; e < 8; ++e) ss += z[j][e] * z[j][e]; }
        const float rstd = 1.0f / sqrtf(wave_sum(ss) * (1.0f / DM) + EPS); float s2 = 0.f;
#pragma unroll
        for (int j = 0; j < 4; ++j) { const f32x4 g0 = ldf4(gpost + 512 * j + 8 * lane), g1 = ldf4(gpost + 512 * j + 8 * lane + 4); const float gg[8] = {g0.x, g0.y, g0.z, g0.w, g1.x, g1.y, g1.z, g1.w};
#pragma unroll
            for (int e = 0; e < 8; ++e) { x[j][e] += z[j][e] * rstd * gg[e]; s2 += x[j][e] * x[j][e]; }
            float* o = P.out + (size_t)m * DM + 512 * j + 8 * lane;
            *(GAS f32x4*)o = (f32x4){x[j][0], x[j][1], x[j][2], x[j][3]}; *(GAS f32x4*)(o + 4) = (f32x4){x[j][4], x[j][5], x[j][6], x[j][7]}; }
        if (gnext) { const float r2 = 1.0f / sqrtf(wave_sum(s2) * (1.0f / DM) + EPS);
#pragma unroll
            for (int j = 0; j < 4; ++j) { const f32x4 g0 = ldf4(gnext + 512 * j + 8 * lane), g1 = ldf4(gnext + 512 * j + 8 * lane + 4); const float gg[8] = {g0.x, g0.y, g0.z, g0.w, g1.x, g1.y, g1.z, g1.w}; float hv[8];
#pragma unroll
                for (int e = 0; e < 8; ++e) hv[e] = x[j][e] * r2 * (unit_next ? 1.0f : gg[e]);
                *(GAS v4u*)(H + (size_t)m * DM + 512 * j + 8 * lane) = f32_to_bf8(hv); } }
    }
}

#ifdef SELFCHECK
__device__ __forceinline__ float bfr(float x) { return __uint_as_float(f2bf(x) << 16); }
__device__ __forceinline__ float bf2f(bf16 v) { return __uint_as_float((unsigned)v << 16); }
__device__ __forceinline__ float dotA(const bf16* Arow, const float* W, int ldw, int col, int K) { float s = 0.f; for (int k = 0; k < K; ++k) s += bf2f(Arow[k]) * bfr(W[(size_t)k * ldw + col]); return s; }
__device__ __forceinline__ void flag_if(const Ptrs& P, float got, float want, unsigned bit) { if (!(fabsf(got - want) <= 0.02f * fabsf(want) + 0.02f)) atomicOr((unsigned*)(P.ws + WS_CTL) + 8, bit); }
__device__ __forceinline__ unsigned hsh(unsigned x) { x ^= x >> 16; x *= 0x7feb352du; x ^= x >> 15; x *= 0x846ca68bu; x ^= x >> 16; return x; }
__device__ __forceinline__ void check_p1(Frame& F, const Ptrs& P) {
    const unsigned id = hsh(F.vcu * 512 + F.tid); const int row = id % S; const int sel = (id >> 13) % 3; const unsigned r2 = hsh(id + 77u);
    const bf16* Hrow = (const bf16*)(P.ws + WS_H) + (size_t)row * DM;
    if (sel == 0) { const int c = r2 % 512; const float a = dotA(Hrow, P.w_in, INW, c, DM), g = dotA(Hrow, P.w_in, INW, 512 + c, DM);
        flag_if(P, bf2f(((const bf16*)(P.ws + WS_GLU))[(size_t)row * 512 + c]), a / (1.f + expf(-g)), 1u); }
    else if (sel == 1) { const int c = r2 % 1024; const float v = dotA(Hrow, P.w_in, INW, 3072 + c, DM); flag_if(P, bf2f(((const bf16*)(P.ws + WS_QKV))[(size_t)row * 3072 + 2048 + c]), v, 2u); }
    else { const int c = r2 % 512; const float v = dotA(Hrow, (const float*)(P.ws + WS_FOLD), CC, c, DM); flag_if(P, bf2f(((const bf16*)(P.ws + WS_POOL))[(size_t)row * 512 + c]), v, 4u); }
}
__device__ __forceinline__ void check_p4(Frame& F, const Ptrs& P, const float* W, unsigned bit) {
    const unsigned id = hsh(F.vcu * 512 + F.tid + 12345u); const int row = id % S; const int c = hsh(id + 5u) % DM;
    float v; if (bit == 8u) v = dotA((const bf16*)(P.ws + WS_Y) + (size_t)row * DM, W, DM, c, DM); else v = dotA((const bf16*)(P.ws + WS_HID) + (size_t)row * FFH, W, DM, c, FFH);
    flag_if(P, bf2f(((const bf16*)(P.ws + WS_Z))[(size_t)row * DM + c]), v, bit);
}
__device__ __forceinline__ void check_p5(Frame& F, const Ptrs& P) {
    const unsigned id = hsh(F.vcu * 512 + F.tid + 999u); const int row = id % S; const int c = hsh(id + 3u) % FFH;
    const bf16* Hrow = (const bf16*)(P.ws + WS_H) + (size_t)row * DM; const float g = dotA(Hrow, P.w_gate, FFH, c, DM), u = dotA(Hrow, P.w_up, FFH, c, DM);
    flag_if(P, bf2f(((const bf16*)(P.ws + WS_HID))[(size_t)row * FFH + c]), g / (1.f + expf(-g)) * u, 16u);
}
#endif

#ifdef SELFCHECK2
__device__ __forceinline__ float bfr(float x) { return __uint_as_float(f2bf(x) << 16); }
__device__ __forceinline__ float bf2f(bf16 v) { return __uint_as_float((unsigned)v << 16); }
__device__ __forceinline__ float dotA(const bf16* Arow, const float* W, int ldw, int col, int K) { float s = 0.f; for (int k = 0; k < K; ++k) s += bf2f(Arow[k]) * bfr(W[(size_t)k * ldw + col]); return s; }
__device__ __forceinline__ void flag_if(const Ptrs& P, float got, float want, unsigned bit) { if (!(fabsf(got - want) <= 0.02f * fabsf(want) + 0.02f)) atomicOr((unsigned*)(P.ws + WS_CTL) + 8, bit); }
__device__ __forceinline__ unsigned hsh(unsigned x) { x ^= x >> 16; x *= 0x7feb352du; x ^= x >> 15; x *= 0x846ca68bu; x ^= x >> 16; return x; }
__device__ __forceinline__ void check_a(Frame& F, const Ptrs& P) {
    const unsigned id = hsh(F.vcu * 512 + F.tid + 4242u); const int row = id % S; const unsigned r2 = hsh(id + 1u);
    const bf16* Hrow = (const bf16*)(P.ws + WS_H) + (size_t)row * DM;
    { float ss = 0.f; const float* xr = P.x + (size_t)row * DM; for (int k = 0; k < DM; ++k) ss += xr[k] * xr[k]; const int c = r2 % DM;
      flag_if(P, bf2f(Hrow[c]), xr[c] / sqrtf(ss / DM + EPS) * P.g_pre_mix[c], 1u); }
    { const int h = (r2 >> 11) % NH, i = (r2 >> 16) % 8; const int sel = (r2 >> 20) & 1;
      const int cb = 1024 + sel * 1024 + h * 64; const float t1 = dotA(Hrow, P.w_in, INW, cb + i, DM), t2 = dotA(Hrow, P.w_in, INW, cb + 8 + i, DM);
      const float inv = powf(500000.0f, -(float)i / 8.0f); const float ang = (float)row * inv; const float c = cosf(ang), s = sinf(ang); const float sc = sel ? 1.0f : 0.125f * 1.4426950408889634f;
      const bf16* qk = (const bf16*)(P.ws + WS_QKV) + (size_t)row * 3072 + sel * 1024 + h * 64;
      flag_if(P, bf2f(qk[i]), (t1 * c - t2 * s) * sc, sel ? 16u : 8u); flag_if(P, bf2f(qk[8 + i]), (t2 * c + t1 * s) * sc, sel ? 16u : 8u);
      const int j = 16 + (r2 >> 21) % 48; const float t3 = dotA(Hrow, P.w_in, INW, cb + j, DM); flag_if(P, bf2f(qk[j]), t3 * sc, sel ? 16u : 8u); }
}
__device__ __forceinline__ void check_b(Frame& F, const Ptrs& P) {
    const unsigned id = hsh(F.vcu * 512 + F.tid + 777u); const int row = id % S; const int seg = (id >> 13) % 3; const int c0 = seg == 0 ? 0 : seg == 1 ? CA : CA + CB, n = seg == 1 ? CB : CA;
    const bf16* Yr = (const bf16*)(P.ws + WS_Y) + (size_t)row * DM + c0; float ss = 0.f; for (int k = 0; k < n; ++k) { const float v = bf2f(Yr[k]) / P.g_mix[c0 + k]; ss += v * v; }
    flag_if(P, sqrtf(ss / n), 1.0f, 32u);
}
__device__ __forceinline__ void check_c(Frame& F, const Ptrs& P) {
    const unsigned id = hsh(F.vcu * 512 + F.tid + 31337u); const int row = id % S; const int c = hsh(id + 9u) % DM;
    const bf16* Zr = (const bf16*)(P.ws + WS_Z) + (size_t)row * DM; const float* xr = P.x + (size_t)row * DM; float ss = 0.f; for (int k = 0; k < DM; ++k) { const float z = bf2f(Zr[k]); ss += z * z; }
    const float rstd = 1.0f / sqrtf(ss / DM + EPS); float s2 = 0.f; for (int k = 0; k < DM; ++k) { const float xn = xr[k] + bf2f(Zr[k]) * rstd * P.g_post_mix[k]; s2 += xn * xn; }
    const float xn = xr[c] + bf2f(Zr[c]) * rstd * P.g_post_mix[c]; flag_if(P, P.out[(size_t)row * DM + c], xn, 2u);
    flag_if(P, bf2f(((const bf16*)(P.ws + WS_H))[(size_t)row * DM + c]), xn / sqrtf(s2 / DM + EPS) * P.g_pre_ffn[c], 4u);
}
#endif

__device__ __forceinline__ int lane_id_asm() { int l; asm volatile("v_mbcnt_lo_u32_b32 %0, -1, 0\n\tv_mbcnt_hi_u32_b32 %0, -1, %0" : "=v"(l)); return l; }
__device__ __forceinline__ Frame make_frame(int s_wave) {
    extern __shared__ __attribute__((aligned(16))) unsigned char lds[];
    Frame F; int tid = s_wave * 64 + lane_id_asm(), bx = blockIdx.x, G = gridDim.x;
    asm volatile("" : "+s"(bx), "+s"(G));
    F.lds = (LAS unsigned char*)lds; F.MISC = (volatile LAS unsigned*)(F.lds + MISC_OFF);
    F.tid = tid; F.lane = tid & 63; F.wave = __builtin_amdgcn_readfirstlane(tid >> 6);
    F.G = G; F.bx = bx; F.vcu = (G % 8 == 0) ? (bx % 8) * (G / 8) + bx / 8 : bx;
    F.gw = F.vcu * NWAVES + F.wave; F.NGW = G * NWAVES; F.ctl = nullptr;
    return F;
}
__global__ void __launch_bounds__(NWAVES * 64, 2) fwd_kernel(Ptrs Pkarg) {
    extern __shared__ __attribute__((aligned(16))) unsigned char lds[];
    { LAS unsigned char* l3 = (LAS unsigned char*)lds; for (int u = threadIdx.x; u < (LDS_BYTES - MISC_OFF) / 4; u += NWAVES * 64) ((LAS unsigned*)(l3 + MISC_OFF))[u] = 0u; }
    __syncthreads();
    XcdBarrier bar;
    { const Ptrs P = load_ptrs(); bar = xcd_barrier_post((unsigned*)((gu32*)(P.ws + WS_CTL) + CW_BAR), (volatile LAS unsigned*)((LAS unsigned char*)lds + MISC_OFF) + 8); }
    const unsigned bar_x = bar.x;
    const int s_wave = __builtin_amdgcn_readfirstlane((int)threadIdx.x >> 6);
#define BARRIER() do { XcdBarrier b_; b_.bar = (unsigned*)((gu32*)(load_ptrs().ws + WS_CTL) + CW_BAR); { unsigned x_ = bar_x; asm volatile("" : "+s"(x_)); b_.x = x_; } b_.st = (volatile LAS unsigned*)((LAS unsigned char*)lds + MISC_OFF) + 8; xcd_barrier(b_, s_wave * 64 + lane_id_asm()); } while (0)

    { const Ptrs P = load_ptrs(); Frame F = make_frame(s_wave); p0a(F, P); } BARRIER();
    { const Ptrs P = load_ptrs(); Frame F = make_frame(s_wave); p0b(F, P); } BARRIER();

    for (int l = 0; l < DEPTH; ++l) {
        {
            const Ptrs P = load_ptrs(); Frame F = make_frame(s_wave); unsigned char* wl = P.ws + WS_W + (size_t)l * LAYER_W;
            pg8::Gemm g{(const bf16*)(P.ws + WS_H), (const bf16*)(wl + WO_IN), S, INW, DM}; pg8::StaticOrder So; So.init(S, INW, F.G, F.bx);
            pg8::EpiWin E{(bf16*)(P.ws + WS_GLU), (bf16*)(P.ws + WS_QKV), (bf16*)(P.ws + WS_POOL), (const float*)(P.ws + WS_ROPE)};
            pg8::gemm_phase<pg8::EpiWin, pg8::StaticOrder, GEMM_ALIGN, GEMM_SP2>(F.lds, g, So, E, F.tid);
        }
        BARRIER();
#ifdef SELFCHECK
        if (l == 0) { const Ptrs P = load_ptrs(); Frame F = make_frame(s_wave); check_p1(F, P); }
#endif
#ifdef SELFCHECK2
        if (l == 0) { const Ptrs P = load_ptrs(); Frame F = make_frame(s_wave); check_a(F, P); }
#endif
        { const Ptrs P = load_ptrs(); Frame F = make_frame(s_wave); attn_phase(F, P); }
        BARRIER();
        { const Ptrs P = load_ptrs(); Frame F = make_frame(s_wave); mix_phase(F, P, l); }
        BARRIER();
        {
            const Ptrs P = load_ptrs(); Frame F = make_frame(s_wave); unsigned char* wl = P.ws + WS_W + (size_t)l * LAYER_W;
            pg8::Gemm g{(const bf16*)(P.ws + WS_Y), (const bf16*)(wl + WO_OUT), S, DM, DM}; pg8::StaticOrder So; So.init(S, DM, F.G, F.bx);
            pg8::EpiPlain E{(bf16*)(P.ws + WS_Z), DM};
            pg8::gemm_phase<pg8::EpiPlain, pg8::StaticOrder, GEMM_ALIGN, GEMM_SP2>(F.lds, g, So, E, F.tid);
        }
        BARRIER();
#ifdef SELFCHECK
        if (l == 0) { const Ptrs P = load_ptrs(); Frame F = make_frame(s_wave); check_p4(F, P, P.w_out, 8u); }
#endif
#ifdef SELFCHECK2
        if (l == 0) { const Ptrs P = load_ptrs(); Frame F = make_frame(s_wave); check_b(F, P); }
#endif
        { const Ptrs P = load_ptrs(); Frame F = make_frame(s_wave); norm_res_phase(F, P, l == 0 ? P.x : P.out, P.g_post_mix + l * DM, P.g_pre_ffn + l * DM); }
        BARRIER();
#ifdef SELFCHECK2
        if (l == 0) { const Ptrs P = load_ptrs(); Frame F = make_frame(s_wave); check_c(F, P); }
#endif
        {
            const Ptrs P = load_ptrs(); Frame F = make_frame(s_wave); unsigned char* wl = P.ws + WS_W + (size_t)l * LAYER_W;
            pg8::Gemm g{(const bf16*)(P.ws + WS_H), (const bf16*)(wl + WO_GU), S, 2 * FFH, DM}; pg8::StaticOrder So; So.init(S, 2 * FFH, F.G, F.bx);
            pg8::EpiSwiglu E{(bf16*)(P.ws + WS_HID), FFH};
            pg8::gemm_phase<pg8::EpiSwiglu, pg8::StaticOrder, GEMM_ALIGN, GEMM_SP2>(F.lds, g, So, E, F.tid);
        }
        BARRIER();
#ifdef SELFCHECK
        if (l == 0) { const Ptrs P = load_ptrs(); Frame F = make_frame(s_wave); check_p5(F, P); }
#endif
        {
            const Ptrs P = load_ptrs(); Frame F = make_frame(s_wave); unsigned char* wl = P.ws + WS_W + (size_t)l * LAYER_W;
            pg8::Gemm g{(const bf16*)(P.ws + WS_HID), (const bf16*)(wl + WO_DN), S, DM, FFH}; pg8::StaticOrder So; So.init(S, DM, F.G, F.bx);
            pg8::EpiPlain E{(bf16*)(P.ws + WS_Z), DM};
            pg8::gemm_phase<pg8::EpiPlain, pg8::StaticOrder, GEMM_ALIGN, GEMM_SP2>(F.lds, g, So, E, F.tid);
        }
        BARRIER();
#ifdef SELFCHECK
        if (l == 0) { const Ptrs P = load_ptrs(); Frame F = make_frame(s_wave); check_p4(F, P, P.w_down, 32u); }
#endif
        { const Ptrs P = load_ptrs(); Frame F = make_frame(s_wave); norm_res_phase(F, P, P.out, P.g_post_ffn + l * DM, l + 1 < DEPTH ? P.g_pre_mix + (l + 1) * DM : nullptr,
#ifdef NO_GPM
            true
#else
            false
#endif
            ); }
        if (l + 1 < DEPTH) BARRIER();
    }
#if defined(SELFCHECK) || defined(SELFCHECK2)
    BARRIER();
    { const Ptrs P = load_ptrs(); if (blockIdx.x == 0 && threadIdx.x == 0) { const unsigned m = __hip_atomic_load((unsigned*)(P.ws + WS_CTL) + 8, __ATOMIC_RELAXED, __HIP_MEMORY_SCOPE_AGENT); if (m) P.out[0] += 1000.0f * (float)m; } }
#endif
#undef BARRIER
}

extern "C" void kernel_launch(void* const* d_in, const int* in_sizes, int n_in, void* d_out, int out_size, void* d_ws, size_t ws_size, hipStream_t stream) {
    static int grid = 0;
    if (grid == 0) {
        const int expect[17] = {S * DM, DEPTH * DM * INW, DEPTH * CONVW * CA, DEPTH * CA, DEPTH * CA, DEPTH * CA, DEPTH * 4 * 128 * 128, DEPTH * CC, DEPTH * DM, DEPTH * DM * DM, DEPTH * DM, DEPTH * DM, DEPTH * DM, DEPTH * DM, DEPTH * DM * FFH, DEPTH * DM * FFH, DEPTH * FFH * DM};
        bool sizes_ok = n_in == 17; for (int i = 0; sizes_ok && i < 17; ++i) sizes_ok = in_sizes[i] == expect[i];
        if (!sizes_ok || out_size != S * DM || ws_size < WS_END) { fprintf(stderr, "kernel_launch: unexpected shapes (n_in %d, in0 %d, out %d, ws %zu); nothing launched\n", n_in, n_in > 0 ? in_sizes[0] : -1, out_size, ws_size); grid = -1; return; }
        int dev = 0, cus = 0, per_cu = 0;
        if (hipGetDevice(&dev) != hipSuccess || hipDeviceGetAttribute(&cus, hipDeviceAttributeMultiprocessorCount, dev) != hipSuccess) { grid = -1; return; }
        if (hipFuncSetAttribute((const void*)fwd_kernel, hipFuncAttributeMaxDynamicSharedMemorySize, LDS_BYTES) != hipSuccess) { fprintf(stderr, "kernel_launch: hipFuncSetAttribute failed\n"); grid = -1; return; }
        if (hipOccupancyMaxActiveBlocksPerMultiprocessor(&per_cu, (const void*)fwd_kernel, NWAVES * 64, LDS_BYTES) != hipSuccess || per_cu < 1) fprintf(stderr, "kernel_launch: occupancy query reports %d\n", per_cu);
        (void)hipGetLastError();
        grid = cus;
    }
    if (grid < 0) return;
    if (hipMemsetAsync((char*)d_ws + WS_CTL, 0, CTL_ZERO_BYTES, stream) != hipSuccess) return;
    Ptrs p{};
    p.x = (const float*)d_in[0]; p.w_in = (const float*)d_in[1]; p.conv_w = (const float*)d_in[2]; p.conv_b = (const float*)d_in[3]; p.conv_ln_g = (const float*)d_in[4]; p.conv_ln_b = (const float*)d_in[5];
    p.pool_w = (const float*)d_in[6]; p.pool_scale = (const float*)d_in[7]; p.g_mix = (const float*)d_in[8]; p.w_out = (const float*)d_in[9]; p.g_pre_mix = (const float*)d_in[10]; p.g_post_mix = (const float*)d_in[11];
    p.g_pre_ffn = (const float*)d_in[12]; p.g_post_ffn = (const float*)d_in[13]; p.w_gate = (const float*)d_in[14]; p.w_up = (const float*)d_in[15]; p.w_down = (const float*)d_in[16];
    p.out = (float*)d_out; p.ws = (unsigned char*)d_ws;
    hipLaunchKernelGGL(fwd_kernel, dim3(grid), dim3(NWAVES * 64), LDS_BYTES, stream, p);
    const hipError_t le = hipPeekAtLastError();
    if (le != hipSuccess) fprintf(stderr, "kernel_launch: launch failed: %s\n", hipGetErrorName(le));
}
```
